# Optimizing an MI355X kernel written in HIP

```python
import jax, jax.numpy as jnp
from jax import lax
import numpy as np

D_MODEL = 2048
BATCH = 16
SEQ = 2048
DEPTH = 1

HEAD_DIM = 64
N_Q_HEADS = 16
N_KV_HEADS = 2
ATTN_WIDTH = N_Q_HEADS * HEAD_DIM
KV_WIDTH = N_KV_HEADS * HEAD_DIM
CONV_WIDTH = D_MODEL - ATTN_WIDTH
MIX_WIDTH = ATTN_WIDTH + CONV_WIDTH
IN_WIDTH = ATTN_WIDTH + 2 * KV_WIDTH + 2 * CONV_WIDTH
WINDOW = 128
BLOCK = 128
CONV_KERNEL = 31
ROPE_THETA = 10000.0
D_FF = -(-8 * D_MODEL // (3 * 256)) * 256
LN_EPS = 1e-5
DEEPNORM_ALPHA = (2 * DEPTH) ** 0.25
DEEPNORM_BETA = (8 * DEPTH) ** -0.25

kernel_name = "hymba_swa_sink_conformer_conv_deepnorm"


def layer_norm(x, g, b):
    xf = x.astype(jnp.float32)
    mu = jnp.mean(xf, axis=-1, keepdims=True)
    var = jnp.mean(jnp.square(xf - mu), axis=-1, keepdims=True)
    y = (xf - mu) * lax.rsqrt(var + LN_EPS)
    return (y * g.astype(jnp.float32) + b.astype(jnp.float32)).astype(x.dtype)


def rope(x, positions):
    half = HEAD_DIM // 2
    inv_freq = 1.0 / (ROPE_THETA ** (jnp.arange(half, dtype=jnp.float32) * 2.0 / HEAD_DIM))
    ang = positions.astype(jnp.float32)[:, :, None] * inv_freq
    cos = jnp.cos(ang)[:, :, None, :]
    sin = jnp.sin(ang)[:, :, None, :]
    xf = x.astype(jnp.float32)
    x1, x2 = xf[..., :half], xf[..., half:]
    out = jnp.concatenate([x1 * cos - x2 * sin, x2 * cos + x1 * sin], axis=-1)
    return out.astype(x.dtype)


def sliding_window_sink_attention(q, k, v, sinks):
    b, s, _, _ = q.shape
    nb = s // BLOCK
    g = N_Q_HEADS // N_KV_HEADS
    qb = q.reshape(b, nb, BLOCK, N_KV_HEADS, g, HEAD_DIM)
    kb = k.reshape(b, nb, BLOCK, N_KV_HEADS, HEAD_DIM)
    vb = v.reshape(b, nb, BLOCK, N_KV_HEADS, HEAD_DIM)
    pad = ((0, 0), (1, 0), (0, 0), (0, 0), (0, 0))
    kk = jnp.concatenate([jnp.pad(kb, pad)[:, :-1], kb], axis=2)
    vv = jnp.concatenate([jnp.pad(vb, pad)[:, :-1], vb], axis=2)
    scores = jnp.einsum('bnqkgd,bnskd->bnkgqs', qb, kk).astype(jnp.float32) * (HEAD_DIM ** -0.5)
    qi = jnp.arange(BLOCK)[:, None]
    si = jnp.arange(2 * BLOCK)[None, :]
    diff = qi + BLOCK - si
    band = (diff >= 0) & (diff < WINDOW)
    key_pos = jnp.arange(nb)[:, None, None] * BLOCK - BLOCK + si[None]
    mask = band[None] & (key_pos >= 0)
    scores = jnp.where(mask[None, :, None, None], scores, -jnp.inf)
    sink = sinks.astype(jnp.float32).reshape(N_KV_HEADS, g)[None, None, :, :, None, None]
    m = jnp.maximum(jnp.max(scores, axis=-1, keepdims=True), sink)
    p = jnp.exp(scores - m)
    denom = jnp.sum(p, axis=-1, keepdims=True) + jnp.exp(sink - m)
    probs = (p / denom).astype(v.dtype)
    out = jnp.einsum('bnkgqs,bnskd->bnqkgd', probs, vv)
    return out.reshape(b, s, ATTN_WIDTH)


def conformer_conv(a, gate, w_dw, b_dw, ln_g, ln_b, w_pw2, b_pw2):
    u = a * jax.nn.sigmoid(gate)
    u = lax.conv_general_dilated(u, w_dw.astype(u.dtype), window_strides=(1,),
                                 padding=[(CONV_KERNEL - 1, 0)],
                                 dimension_numbers=('NWC', 'WIO', 'NWC'),
                                 feature_group_count=CONV_WIDTH) + b_dw
    u = jax.nn.silu(layer_norm(u, ln_g, ln_b))
    return u @ w_pw2 + b_pw2


def setup_inputs(seed: int = 0) -> dict:
    key = jax.random.key(seed)
    ks = jax.random.split(key, 24)
    f32 = jnp.float32
    nrm = lambda k, shape, scale: jax.random.normal(k, shape, f32) * scale
    L = DEPTH
    x = jax.random.normal(ks[0], (BATCH, SEQ, D_MODEL), f32)
    offsets = jax.random.randint(ks[1], (BATCH, 1), 0, 4096, dtype=jnp.int32)
    positions = offsets + jnp.arange(SEQ, dtype=jnp.int32)[None, :]
    return {
        "x": x,
        "positions": positions,
        "w_in": nrm(ks[2], (L, D_MODEL, IN_WIDTH), D_MODEL ** -0.5),
        "b_in": nrm(ks[3], (L, IN_WIDTH), 0.02),
        "sinks": nrm(ks[4], (L, N_Q_HEADS), 0.5),
        "w_dw": nrm(ks[5], (L, CONV_KERNEL, 1, CONV_WIDTH), CONV_KERNEL ** -0.5),
        "b_dw": nrm(ks[6], (L, CONV_WIDTH), 0.02),
        "conv_ln_g": 1.0 + nrm(ks[7], (L, CONV_WIDTH), 0.02),
        "conv_ln_b": nrm(ks[8], (L, CONV_WIDTH), 0.02),
        "w_pw2": nrm(ks[9], (L, CONV_WIDTH, CONV_WIDTH), CONV_WIDTH ** -0.5),
        "b_pw2": nrm(ks[10], (L, CONV_WIDTH), 0.02),
        "w_out": nrm(ks[11], (L, MIX_WIDTH, D_MODEL), MIX_WIDTH ** -0.5 * DEEPNORM_BETA),
        "b_out": nrm(ks[12], (L, D_MODEL), 0.02),
        "ln1_g": 1.0 + nrm(ks[13], (L, D_MODEL), 0.02),
        "ln1_b": nrm(ks[14], (L, D_MODEL), 0.02),
        "w_gate": nrm(ks[15], (L, D_MODEL, D_FF), D_MODEL ** -0.5),
        "w_up": nrm(ks[16], (L, D_MODEL, D_FF), D_MODEL ** -0.5),
        "w_down": nrm(ks[17], (L, D_FF, D_MODEL), D_FF ** -0.5 * DEEPNORM_BETA),
        "ln2_g": 1.0 + nrm(ks[18], (L, D_MODEL), 0.02),
        "ln2_b": nrm(ks[19], (L, D_MODEL), 0.02),
    }


def reference(x, positions, w_in, b_in, sinks, w_dw, b_dw, conv_ln_g, conv_ln_b, w_pw2, b_pw2,
              w_out, b_out, ln1_g, ln1_b, w_gate, w_up, w_down, ln2_g, ln2_b):
    b, s, _ = x.shape
    o_k = ATTN_WIDTH
    o_v = o_k + KV_WIDTH
    o_a = o_v + KV_WIDTH
    o_g = o_a + CONV_WIDTH
    for l in range(DEPTH):
        h = x @ w_in[l] + b_in[l]
        q = rope(h[..., :o_k].reshape(b, s, N_Q_HEADS, HEAD_DIM), positions)
        k = rope(h[..., o_k:o_v].reshape(b, s, N_KV_HEADS, HEAD_DIM), positions)
        v = h[..., o_v:o_a].reshape(b, s, N_KV_HEADS, HEAD_DIM)
        attn = sliding_window_sink_attention(q, k, v, sinks[l])
        conv = conformer_conv(h[..., o_a:o_g], h[..., o_g:], w_dw[l], b_dw[l],
                              conv_ln_g[l], conv_ln_b[l], w_pw2[l], b_pw2[l])
        mix = jnp.concatenate([attn, conv], axis=-1) @ w_out[l] + b_out[l]
        x = layer_norm(DEEPNORM_ALPHA * x + mix, ln1_g[l], ln1_b[l])
        ffn = (jax.nn.silu(x @ w_gate[l]) * (x @ w_up[l])) @ w_down[l]
        x = layer_norm(DEEPNORM_ALPHA * x + ffn, ln2_g[l], ln2_b[l])
    return x
```

```cpp
#include <hip/hip_runtime.h>
#include <hip/hip_cooperative_groups.h>
#include <cstdio>
#include <cstdint>
namespace cg = cooperative_groups;
#ifndef MK_N_LAUNCHES
#define MK_N_LAUNCHES 1
#endif
namespace pg8 {
#define PG8_LAS __attribute__((address_space(3)))
typedef unsigned short bf16_t;
typedef short bf16x8 __attribute__((ext_vector_type(8)));
typedef float f32x4 __attribute__((ext_vector_type(4)));
typedef unsigned u32x4 __attribute__((ext_vector_type(4)));
constexpr int BM = 256, BK = 64, HALF = 128, HTB = HALF * BK * 2  , STAGE_BYTES = 8 * HTB, NXCD = 8, WGM = 8;

__host__ __device__ __forceinline__ int lds_byte(int r, int c) { const int st = (r >> 4) * 2 + (c >> 5), rr = r & 15, cc = c & 31, ob = rr * 64 + cc * 2; return st * 1024 + (ob ^ (((ob >> 9) & 1) << 5)); }
__host__ __device__ __forceinline__ void stage_rc(int b, int& R, int& C) { const int st = b / 1024, sb = b % 1024, swz = sb ^ (((sb >> 9) & 1) << 5); R = (st >> 1) * 16 + swz / 64; C = (st & 1) * 32 + (swz % 64) / 2; }
__host__ __device__ __forceinline__ int perm32(int rho) { const int n = rho >> 4, i = rho & 15; return 8 * (i >> 2) + 4 * n + (i & 3); }

struct Unit { int pm, pn; };
struct Gemm { const bf16_t* A; const bf16_t* Bt; int M, N, K; };

struct StaticOrder {
    int nM, nN, nwg, G, c;
    __host__ __device__ void init(int M, int N, int G_, int c_) { nM = M / BM; nN = N / BM; nwg = nM * nN; G = G_; c = c_; }
    __host__ __device__ bool next(int i, Unit& u) const {
        const long L = (long)i * G + c; if (L >= nwg) return false;
        int wgid = (int)L; { const int q = nwg / NXCD, r = nwg % NXCD, xcd = wgid % NXCD, off = wgid / NXCD; wgid = (xcd < r ? xcd * (q + 1) : r * (q + 1) + (xcd - r) * q) + off; }
        const int nig = WGM * nN, gid = wgid / nig, fm = gid * WGM, gsz = (nM - fm) < WGM ? (nM - fm) : WGM;
        u.pm = fm + ((wgid % nig) % gsz); u.pn = (wgid % nig) / gsz; return true;
    }
    __device__ __forceinline__ void a_ready(const Unit&) const {}
    __device__ __forceinline__ void done(const Unit&) const {}
};

__device__ __forceinline__ unsigned cvt_pk_bf16(float lo, float hi) { unsigned r; asm volatile("v_cvt_pk_bf16_f32 %0, %1, %2" : "=v"(r) : "v"(lo), "v"(hi)); return r; }
typedef float f32x2 __attribute__((ext_vector_type(2)));
__device__ __forceinline__ float sigmoidf_fast(float g) { return __builtin_amdgcn_rcpf(1.0f + __builtin_amdgcn_exp2f(-1.4426950408889634f * g)); }
__device__ __forceinline__ u32x4 pack8(const f32x4 a, const f32x4 b) { u32x4 w; w.x = cvt_pk_bf16(a[0], a[1]); w.y = cvt_pk_bf16(a[2], a[3]); w.z = cvt_pk_bf16(b[0], b[1]); w.w = cvt_pk_bf16(b[2], b[3]); return w; }
constexpr float QSCALE = 0.125f * 1.4426950408889634f;

struct EpiIn {
    static constexpr bool PERM = true, AFTER_DRAIN = false;
    bf16_t *Q, *Kb, *Vb, *U; const float* bias; const float* cs; const float* sn;
    __device__ __forceinline__ void operator()(const f32x4 (&acc)[2][2][4][2], const Unit& u, int wr, int wc, int fr, int fq) const {
        const int row0 = u.pm * BM + wr * 64 + fr;
        if (u.pn < 5) {
            const int cbase = u.pn * 256 + wc * 64 + 8 * fq;
            f32x4 b0[2], b1[2];
#pragma unroll
            for (int n = 0; n < 2; ++n) { b0[n] = *(const f32x4*)(bias + cbase + 4 * n); b1[n] = *(const f32x4*)(bias + cbase + 32 + 4 * n); }
            const bool rope = (u.pn < 4) || (wc < 2);
            const float sc = (u.pn < 4) ? QSCALE : 1.0f;
            bf16_t* dst; int ld;
            if (u.pn < 4) { dst = Q + u.pn * 256 + wc * 64 + 8 * fq; ld = 1024; }
            else if (wc < 2) { dst = Kb + wc * 64 + 8 * fq; ld = 128; }
            else { dst = Vb + (wc - 2) * 64 + 8 * fq; ld = 128; }
#pragma unroll
            for (int ai = 0; ai < 2; ++ai)
#pragma unroll
                for (int m = 0; m < 4; ++m) {
                    const int row = row0 + ai * HALF + m * 16;
                    f32x4 x1[2], x2[2];
#pragma unroll
                    for (int n = 0; n < 2; ++n) { x1[n] = acc[ai][0][m][n] + b0[n]; x2[n] = acc[ai][1][m][n] + b1[n]; }
                    if (rope) {
#pragma unroll
                        for (int n = 0; n < 2; ++n) {
                            const f32x4 c = *(const f32x4*)(cs + (size_t)row * 32 + 8 * fq + 4 * n), s = *(const f32x4*)(sn + (size_t)row * 32 + 8 * fq + 4 * n);
                            const f32x4 o1 = (x1[n] * c - x2[n] * s) * sc, o2 = (x2[n] * c + x1[n] * s) * sc;
                            x1[n] = o1; x2[n] = o2;
                        }
                    }
                    bf16_t* rp = dst + (size_t)row * ld;
                    *(u32x4*)(rp) = pack8(x1[0], x1[1]);
                    *(u32x4*)(rp + 32) = pack8(x2[0], x2[1]);
                }
        } else {
            const int ch0 = 128 * (u.pn - 5) + 32 * wc + 8 * fq;
            f32x4 ba[2], bg[2];
#pragma unroll
            for (int n = 0; n < 2; ++n) { ba[n] = *(const f32x4*)(bias + 1280 + ch0 + 4 * n); bg[n] = *(const f32x4*)(bias + 2304 + ch0 + 4 * n); }
#pragma unroll
            for (int ai = 0; ai < 2; ++ai)
#pragma unroll
                for (int m = 0; m < 4; ++m) {
                    const int row = row0 + ai * HALF + m * 16;
                    f32x4 o[2];
#pragma unroll
                    for (int n = 0; n < 2; ++n) {
                        const f32x4 a = acc[ai][0][m][n] + ba[n], g = acc[ai][1][m][n] + bg[n];
                        o[n] = (f32x4){a[0] * sigmoidf_fast(g[0]), a[1] * sigmoidf_fast(g[1]), a[2] * sigmoidf_fast(g[2]), a[3] * sigmoidf_fast(g[3])};
                    }
                    *(u32x4*)(U + (size_t)row * 1024 + ch0) = pack8(o[0], o[1]);
                }
        }
    }
};
struct EpiBias16 {
    static constexpr bool PERM = true, AFTER_DRAIN = false;
    bf16_t* O; int ldc; int col_off; const float* bias;
    __device__ __forceinline__ void operator()(const f32x4 (&acc)[2][2][4][2], const Unit& u, int wr, int wc, int fr, int fq) const {
        const int row0 = u.pm * BM + wr * 64 + fr, col0 = u.pn * BM + wc * 32 + 8 * fq;
        f32x4 bv[2][2];
#pragma unroll
        for (int bj = 0; bj < 2; ++bj)
#pragma unroll
            for (int n = 0; n < 2; ++n) bv[bj][n] = *(const f32x4*)(bias + col0 + bj * HALF + 4 * n);
#pragma unroll
        for (int ai = 0; ai < 2; ++ai)
#pragma unroll
            for (int m = 0; m < 4; ++m) { bf16_t* rowp = O + (size_t)(row0 + ai * HALF + m * 16) * ldc + col_off + col0;
#pragma unroll
                for (int bj = 0; bj < 2; ++bj) *(u32x4*)(rowp + bj * HALF) = pack8(acc[ai][bj][m][0] + bv[bj][0], acc[ai][bj][m][1] + bv[bj][1]); }
    }
};
struct EpiSwiGLU {
    static constexpr bool PERM = true, AFTER_DRAIN = false;
    bf16_t* H; int ldc;
    __device__ __forceinline__ void operator()(const f32x4 (&acc)[2][2][4][2], const Unit& u, int wr, int wc, int fr, int fq) const {
        const int row0 = u.pm * BM + wr * 64 + fr, col0 = u.pn * HALF + wc * 32 + 8 * fq;
#pragma unroll
        for (int ai = 0; ai < 2; ++ai)
#pragma unroll
            for (int m = 0; m < 4; ++m) {
                f32x4 o[2];
#pragma unroll
                for (int n = 0; n < 2; ++n) { const f32x4 g = acc[ai][0][m][n], v = acc[ai][1][m][n];
                    o[n] = (f32x4){g[0] * sigmoidf_fast(g[0]) * v[0], g[1] * sigmoidf_fast(g[1]) * v[1], g[2] * sigmoidf_fast(g[2]) * v[2], g[3] * sigmoidf_fast(g[3]) * v[3]}; }
                *(u32x4*)(H + (size_t)(row0 + ai * HALF + m * 16) * ldc + col0) = pack8(o[0], o[1]);
            }
    }
};
struct EpiRes {
    static constexpr bool PERM = true, AFTER_DRAIN = false;
    const float* res; float* Y; int ldc; const float* bias; float alpha;
    __device__ __forceinline__ void operator()(const f32x4 (&acc)[2][2][4][2], const Unit& u, int wr, int wc, int fr, int fq) const {
        const int row0 = u.pm * BM + wr * 64 + fr, col0 = u.pn * BM + wc * 32 + 8 * fq;
        f32x4 bv[2][2];
#pragma unroll
        for (int bj = 0; bj < 2; ++bj)
#pragma unroll
            for (int n = 0; n < 2; ++n) bv[bj][n] = bias ? *(const f32x4*)(bias + col0 + bj * HALF + 4 * n) : (f32x4){0.f, 0.f, 0.f, 0.f};
#pragma unroll
        for (int ai = 0; ai < 2; ++ai)
#pragma unroll
            for (int m = 0; m < 4; ++m) { const size_t off = (size_t)(row0 + ai * HALF + m * 16) * ldc + col0;
#pragma unroll
                for (int bj = 0; bj < 2; ++bj)
#pragma unroll
                    for (int n = 0; n < 2; ++n) { const f32x4 r = *(const f32x4*)(res + off + bj * HALF + 4 * n);
                        *(f32x4*)(Y + off + bj * HALF + 4 * n) = r * alpha + acc[ai][bj][m][n] + bv[bj][n]; } }
    }
};

template <class Epi, class Sched, bool ALIGN_EPI = false, bool SP2 = false>
__device__ __forceinline__ void gemm_phase(PG8_LAS unsigned char* lds, const Gemm g, const Sched& S, const Epi& E) {
    const int tid = threadIdx.x, wid = __builtin_amdgcn_readfirstlane(tid >> 6), lane = tid & 63, wr = wid >> 2, wc = wid & 3, fr = lane & 15, fq = lane >> 4;
    const int K = g.K, nt = K / BK;
    unsigned voffA[2], voffB[2];
#pragma unroll
    for (int i = 0; i < 2; ++i) { int R, C; stage_rc(tid * 16 + i * 8192, R, C); const int Rb = Epi::PERM ? ((R & ~31) + perm32(R & 31)) : R;
        voffA[i] = (unsigned)(R * K + C) * 2u; voffB[i] = (unsigned)(Rb * K + C) * 2u; }
    const size_t kstep = (size_t)(BK * 2);
    const size_t hstep = (size_t)HALF * K * 2;
    const size_t tstep = 2 * hstep;
    const unsigned ldsw = (unsigned)wid * 1024u;
    const int aoff = lds_byte(wr * 64 + fr, fq * 8), boff = lds_byte(wc * 32 + fr, fq * 8);
#define PG8_SA(b, h) (((b) * 2 + (h)) * HTB)
#define PG8_SB(b, h) ((4 + (b) * 2 + (h)) * HTB)
#define PG8_STAGE(bufoff, gbase, voff) do { _Pragma("unroll") for (int _i = 0; _i < 2; ++_i) \
        __builtin_amdgcn_global_load_lds((const unsigned*)((const char*)(gbase) + (voff)[_i]), (PG8_LAS unsigned*)(lds + (bufoff) + ldsw + _i * 8192), 16, 0, 0); } while (0)
#define PG8_LDA(dst, b, h) do { _Pragma("unroll") for (int m = 0; m < 4; ++m) _Pragma("unroll") for (int k = 0; k < 2; ++k) dst[m][k] = *(const PG8_LAS bf16x8*)(lds + PG8_SA(b, h) + aoff + m * 2048 + k * 1024); } while (0)
#define PG8_LDB(dst, b, h) do { _Pragma("unroll") for (int n = 0; n < 2; ++n) _Pragma("unroll") for (int k = 0; k < 2; ++k) dst[n][k] = *(const PG8_LAS bf16x8*)(lds + PG8_SB(b, h) + boff + n * 2048 + k * 1024); } while (0)
#define PG8_MMA(ai, bj, At, Bt) do { __builtin_amdgcn_s_setprio(1); _Pragma("unroll") for (int m = 0; m < 4; ++m) _Pragma("unroll") for (int n = 0; n < 2; ++n) _Pragma("unroll") for (int k = 0; k < 2; ++k) \
        acc[ai][bj][m][n] = __builtin_amdgcn_mfma_f32_16x16x32_bf16(Bt[n][k], At[m][k], acc[ai][bj][m][n], 0, 0, 0); __builtin_amdgcn_s_setprio(0); } while (0)
#define PG8_WAIT_V(n) asm volatile("s_waitcnt vmcnt(" #n ")" ::: "memory")
#define PG8_WAIT_L(n) asm volatile("s_waitcnt lgkmcnt(" #n ")" ::: "memory")
#define PG8_BAR __builtin_amdgcn_s_barrier()
#define PG8_SCHED __builtin_amdgcn_sched_barrier(0)
    Unit cur, nxt; int ui = 0;
    if (!S.next(0, cur)) return;
    f32x4 acc[2][2][4][2];
#pragma unroll
    for (int a = 0; a < 2; ++a)
#pragma unroll
        for (int b = 0; b < 2; ++b)
#pragma unroll
            for (int m = 0; m < 4; ++m)
#pragma unroll
                for (int n = 0; n < 2; ++n) acc[a][b][m][n] = (f32x4){0.f, 0.f, 0.f, 0.f};
    bf16x8 At[4][2], B0[2][2], B1[2][2];
    const char* cA = (const char*)g.A + (size_t)cur.pm * tstep; const char* cB = (const char*)g.Bt + (size_t)cur.pn * tstep;
    S.a_ready(cur);
    if constexpr (SP2) {
        PG8_STAGE(PG8_SB(0, 0), cB, voffB); PG8_STAGE(PG8_SB(0, 1), cB + hstep, voffB); PG8_STAGE(PG8_SA(0, 0), cA, voffA); PG8_STAGE(PG8_SA(0, 1), cA + hstep, voffA);
        if (wr == 1) PG8_BAR;
        PG8_WAIT_V(2); PG8_BAR;
        PG8_STAGE(PG8_SB(1, 0), cB + kstep, voffB); PG8_STAGE(PG8_SA(1, 0), cA + kstep, voffA); PG8_STAGE(PG8_SB(1, 1), cB + hstep + kstep, voffB);
        PG8_WAIT_V(6); PG8_BAR;
    } else {
        PG8_STAGE(PG8_SB(0, 0), cB, voffB); PG8_STAGE(PG8_SA(0, 0), cA, voffA); PG8_STAGE(PG8_SB(0, 1), cB + hstep, voffB); PG8_STAGE(PG8_SA(0, 1), cA + hstep, voffA);
        if (wr == 1) PG8_BAR;
        PG8_WAIT_V(4); PG8_BAR;
        PG8_STAGE(PG8_SB(1, 0), cB + kstep, voffB); PG8_STAGE(PG8_SA(1, 0), cA + kstep, voffA); PG8_STAGE(PG8_SB(1, 1), cB + hstep + kstep, voffB);
        PG8_WAIT_V(6); PG8_BAR;
    }
    for (;;) {
        const bool has_next = S.next(ui + 1, nxt);
        const char* nA = has_next ? (const char*)g.A + (size_t)nxt.pm * tstep : cA; const char* nB = has_next ? (const char*)g.Bt + (size_t)nxt.pn * tstep : cB;
        for (int t = 0; t < nt; t += 2) {
            const bool last = (t == nt - 2);
            const char* a1 = cA + (size_t)(t + 1) * kstep;
            const char* a2 = last ? nA : cA + (size_t)(t + 2) * kstep; const char* b2 = last ? nB : cB + (size_t)(t + 2) * kstep;
            const char* a3 = a2 + kstep; const char* b3 = b2 + kstep;
            if (last && has_next) S.a_ready(nxt);
            if constexpr (SP2) {
            PG8_LDB(B0, 0, 0); PG8_LDB(B1, 0, 1); PG8_SCHED; PG8_LDA(At, 0, 0); PG8_STAGE(PG8_SA(1, 1), a1 + hstep, voffA);
            PG8_WAIT_V(8); PG8_WAIT_L(0); PG8_BAR; PG8_MMA(0, 0, At, B0); PG8_MMA(0, 1, At, B1); PG8_BAR; PG8_SCHED;
            PG8_LDA(At, 0, 1); PG8_STAGE(PG8_SB(0, 0), b2, voffB); PG8_STAGE(PG8_SB(0, 1), b2 + hstep, voffB); PG8_STAGE(PG8_SA(0, 0), a2, voffA);
            PG8_WAIT_V(8); PG8_WAIT_L(0); PG8_BAR; PG8_MMA(1, 0, At, B0); PG8_MMA(1, 1, At, B1); PG8_BAR; PG8_SCHED;
            PG8_LDB(B0, 1, 0); PG8_LDB(B1, 1, 1); PG8_SCHED; PG8_LDA(At, 1, 0); PG8_STAGE(PG8_SA(0, 1), a2 + hstep, voffA);
            PG8_WAIT_V(8); PG8_WAIT_L(0); PG8_BAR; PG8_MMA(0, 0, At, B0); PG8_MMA(0, 1, At, B1); PG8_BAR; PG8_SCHED;
            PG8_LDA(At, 1, 1); PG8_STAGE(PG8_SB(1, 0), b3, voffB); PG8_STAGE(PG8_SB(1, 1), b3 + hstep, voffB); PG8_STAGE(PG8_SA(1, 0), a3, voffA);
            PG8_WAIT_V(8); PG8_WAIT_L(0); PG8_BAR; PG8_MMA(1, 0, At, B0); PG8_MMA(1, 1, At, B1); PG8_BAR; PG8_SCHED;
            } else {
            PG8_LDB(B0, 0, 0); PG8_SCHED; PG8_LDA(At, 0, 0); PG8_STAGE(PG8_SA(1, 1), a1 + hstep, voffA);
            PG8_WAIT_L(8); PG8_BAR; PG8_WAIT_L(0); PG8_MMA(0, 0, At, B0); PG8_BAR; PG8_SCHED;
            PG8_LDB(B1, 0, 1); PG8_STAGE(PG8_SB(0, 0), b2, voffB);
            PG8_BAR; PG8_WAIT_L(0); PG8_MMA(0, 1, At, B1); PG8_BAR;
            PG8_LDA(At, 0, 1); PG8_STAGE(PG8_SA(0, 0), a2, voffA);
            PG8_BAR; PG8_WAIT_L(0); PG8_MMA(1, 0, At, B0); PG8_BAR; PG8_SCHED;
            PG8_STAGE(PG8_SB(0, 1), b2 + hstep, voffB);
            PG8_WAIT_V(6); PG8_BAR; PG8_MMA(1, 1, At, B1); PG8_BAR;
            PG8_LDB(B0, 1, 0); PG8_SCHED; PG8_LDA(At, 1, 0); PG8_STAGE(PG8_SA(0, 1), a2 + hstep, voffA);
            PG8_WAIT_L(8); PG8_BAR; PG8_WAIT_L(0); PG8_MMA(0, 0, At, B0); PG8_BAR; PG8_SCHED;
            PG8_LDB(B1, 1, 1); PG8_STAGE(PG8_SB(1, 0), b3, voffB);
            PG8_BAR; PG8_WAIT_L(0); PG8_MMA(0, 1, At, B1); PG8_BAR;
            PG8_LDA(At, 1, 1); PG8_STAGE(PG8_SA(1, 0), a3, voffA);
            PG8_BAR; PG8_WAIT_L(0); PG8_MMA(1, 0, At, B0); PG8_BAR; PG8_SCHED;
            PG8_STAGE(PG8_SB(1, 1), b3 + hstep, voffB);
            PG8_WAIT_V(6); PG8_BAR; PG8_MMA(1, 1, At, B1); PG8_BAR;
            }
        }
        if constexpr (ALIGN_EPI) { if (wr == 0) PG8_BAR; }
        if constexpr (!Epi::AFTER_DRAIN) { E(acc, cur, wr, wc, fr, fq); S.done(cur); }
        if (!has_next) break;
#pragma unroll
        for (int a = 0; a < 2; ++a)
#pragma unroll
            for (int b = 0; b < 2; ++b)
#pragma unroll
                for (int m = 0; m < 4; ++m)
#pragma unroll
                    for (int n = 0; n < 2; ++n) acc[a][b][m][n] = (f32x4){0.f, 0.f, 0.f, 0.f};
        cur = nxt; cA = nA; cB = nB; ++ui;
        if constexpr (ALIGN_EPI) { if (wr == 1) PG8_BAR; }
    }
    PG8_WAIT_V(0);
    if constexpr (!ALIGN_EPI) { if (wr == 0) PG8_BAR; }
    PG8_BAR;
    if constexpr (Epi::AFTER_DRAIN) { E.fused(acc, cur, wr, wc, fr, fq, lds, wid, lane); S.done(cur); }
#undef PG8_SA
#undef PG8_SB
#undef PG8_STAGE
#undef PG8_LDA
#undef PG8_LDB
#undef PG8_MMA
#undef PG8_WAIT_V
#undef PG8_WAIT_L
#undef PG8_BAR
#undef PG8_SCHED
}
}
#define LAS __attribute__((address_space(3)))
typedef unsigned short bf16;
typedef unsigned u32x4 __attribute__((ext_vector_type(4)));
typedef unsigned u32x2 __attribute__((ext_vector_type(2)));
typedef float f32x4 __attribute__((ext_vector_type(4)));
typedef float f32x2 __attribute__((ext_vector_type(2)));
typedef float f32x16 __attribute__((ext_vector_type(16)));
typedef short bf16x8 __attribute__((ext_vector_type(8)));
typedef short s16x4 __attribute__((ext_vector_type(4)));

constexpr int NWAVES = 8, NTHR = 512;
constexpr int BATCH = 16, SEQ = 2048, DM = 2048, M = BATCH * SEQ, NIN = 3328, CWID = 1024, DFF = 5632, NQH = 16, HD = 64;
constexpr float LN_EPS = 1e-5f, ALPHA = 1.189207115002721f;
constexpr int N_PHASES = 9;

constexpr size_t MiB = 1u << 20;
constexpr size_t WS_ROPE = 2 * MiB;
constexpr size_t WS_WIN = 10 * MiB;
constexpr size_t WS_WPW = 23 * MiB;
constexpr size_t WS_WOUT = 25 * MiB;
constexpr size_t WS_WGU = 33 * MiB;
constexpr size_t WS_WDN = 77 * MiB;
constexpr size_t WS_XB = 100 * MiB;
constexpr size_t WS_Q = 228 * MiB;
constexpr size_t WS_K = 292 * MiB;
constexpr size_t WS_V = 300 * MiB;
constexpr size_t WS_U = 308 * MiB;
constexpr size_t WS_U2 = 372 * MiB;
constexpr size_t WS_MIX = 436 * MiB;
constexpr size_t WS_H = 100 * MiB;
constexpr size_t WS_Y = 564 * MiB;
constexpr size_t WS_X1B = 820 * MiB;
constexpr size_t WS_END = 948 * MiB;
constexpr int LDS_BYTES = 147456;

__device__ __forceinline__ float wave_sum(float v) {
#pragma unroll
    for (int o = 1; o < 64; o <<= 1) v += __shfl_xor(v, o);
    return v;
}
__device__ __forceinline__ float bf_lo(unsigned w) { return __uint_as_float(w << 16); }
__device__ __forceinline__ float bf_hi(unsigned w) { return __uint_as_float(w & 0xffff0000u); }

__device__ __forceinline__ void transpose_item(const float* __restrict__ W, int ldw, int src_col0, int k0, bf16* __restrict__ WT, int K, int dst_row0, LAS float* scr, int lane) {
#pragma unroll 8
    for (int i = 0; i < 32; ++i) { const int kk = 2 * i + (lane >> 5); scr[kk * 33 + (lane & 31)] = W[(size_t)(k0 + kk) * ldw + src_col0 + (lane & 31)]; }
    asm volatile("s_waitcnt lgkmcnt(0)" ::: "memory");
    const int c = lane & 7;
#pragma unroll
    for (int j = 0; j < 4; ++j) { const int n = (lane >> 3) + 8 * j; const LAS float* s = scr + (8 * c) * 33 + n;
        u32x4 o; o.x = pg8::cvt_pk_bf16(s[0 * 33], s[1 * 33]); o.y = pg8::cvt_pk_bf16(s[2 * 33], s[3 * 33]); o.z = pg8::cvt_pk_bf16(s[4 * 33], s[5 * 33]); o.w = pg8::cvt_pk_bf16(s[6 * 33], s[7 * 33]);
        *(u32x4*)(WT + (size_t)(dst_row0 + n) * K + k0 + 8 * c) = o; }
    asm volatile("s_waitcnt lgkmcnt(0)" ::: "memory");
}

struct Args { const void* in[20]; float* out; unsigned char* ws; int ph_lo, ph_hi; };

__device__ __forceinline__ void prologue(const Args& a, LAS unsigned char* lds, int tid, int lane, int wave, int blk, int G) {
    const float* w_in = (const float*)a.in[2]; const float* w_pw2 = (const float*)a.in[9]; const float* w_out = (const float*)a.in[11];
    const float* w_gate = (const float*)a.in[15]; const float* w_up = (const float*)a.in[16]; const float* w_down = (const float*)a.in[17];
    unsigned char* ws = a.ws;
    LAS float* scr = (LAS float*)(lds + wave * 8704);
    const int gw = blk * NWAVES + wave, NGW = G * NWAVES;
    constexpr int I_IN = 32 * 104, I_PW = 16 * 32, I_OUT = 32 * 64, I_GU = 32 * 352, I_DN = 88 * 64, NITEMS = I_IN + I_PW + I_OUT + I_GU + I_DN;
    for (int it = gw; it < NITEMS; it += NGW) {
        int r = it;
        if (r < I_IN) { const int kb = r / 104, sg = r % 104, pn = sg >> 3, bj = (sg >> 2) & 1, wc = sg & 3;
            const int src = pn < 5 ? 256 * pn + 64 * wc + 32 * bj : (bj ? 2304 : 1280) + 128 * (pn - 5) + 32 * wc;
            transpose_item(w_in, NIN, src, 64 * kb, (bf16*)(ws + WS_WIN), DM, 32 * sg, scr, lane); continue; }
        r -= I_IN;
        if (r < I_PW) { const int kb = r / 32, sg = r % 32; transpose_item(w_pw2, CWID, 32 * sg, 64 * kb, (bf16*)(ws + WS_WPW), CWID, 32 * sg, scr, lane); continue; }
        r -= I_PW;
        if (r < I_OUT) { const int kb = r / 64, sg = r % 64; transpose_item(w_out, DM, 32 * sg, 64 * kb, (bf16*)(ws + WS_WOUT), DM, 32 * sg, scr, lane); continue; }
        r -= I_OUT;
        if (r < I_GU) { const int kb = r / 352, sg = r % 352, pn = sg >> 3, bj = (sg >> 2) & 1, wc = sg & 3;
            transpose_item(bj ? w_up : w_gate, DFF, 128 * pn + 32 * wc, 64 * kb, (bf16*)(ws + WS_WGU), DM, 32 * sg, scr, lane); continue; }
        r -= I_GU;
        { const int kb = r / 64, sg = r % 64; transpose_item(w_down, DM, 32 * sg, 64 * kb, (bf16*)(ws + WS_WDN), DFF, 32 * sg, scr, lane); }
    }
    const size_t gt = (size_t)blk * NTHR + tid, GT = (size_t)G * NTHR;
    { const f32x4* x4 = (const f32x4*)a.in[0]; u32x4* xb = (u32x4*)(ws + WS_XB); const size_t n8 = (size_t)M * DM / 8;
#pragma unroll 4
        for (size_t i = gt; i < n8; i += GT) { const f32x4 p = x4[2 * i], q = x4[2 * i + 1]; xb[i] = pg8::pack8(p, q); } }
    { const int* pos = (const int*)a.in[1]; float* cs = (float*)(ws + WS_ROPE); float* sn = cs + (size_t)M * 32;
        for (size_t idx = gt; idx < (size_t)M * 32; idx += GT) { const int m = (int)(idx >> 5), i = (int)(idx & 31);
            const float e = (float)i * 2.0f / 64.0f; const float inv = 1.0f / powf(10000.0f, e); const float ang = (float)pos[m] * inv;
            double rv = (double)ang * 0.15915494309189535; rv -= floor(rv); const float fr = (float)rv;
            cs[idx] = __builtin_amdgcn_cosf(fr); sn[idx] = __builtin_amdgcn_sinf(fr); } }
}

constexpr int KS_PITCH = 144, VT_PITCH = 520, ALDS_K = 0, ALDS_VT = 256 * KS_PITCH;
__device__ __forceinline__ int crow(int r, int hi) { return (r & 3) + 8 * (r >> 2) + 4 * hi; }
__device__ __forceinline__ void attn_item(LAS unsigned char* lds, int b, int nb, int kvh, const bf16* __restrict__ Qb, const bf16* __restrict__ Kb, const bf16* __restrict__ Vb, bf16* __restrict__ MIX,
                                          const float* __restrict__ sinks, int tid, int lane, int wave) {
    const int tok0 = nb * 128 - 128;
    LAS unsigned short* vt = (LAS unsigned short*)(lds + ALDS_VT);
#pragma unroll
    for (int c = tid; c < 2048; c += NTHR) {
        const int r = c >> 3, ch = c & 7, tok = tok0 + r;
        u32x4 kv = (u32x4){0u, 0u, 0u, 0u}, vv = (u32x4){0u, 0u, 0u, 0u};
        if (tok >= 0) { const size_t off = (size_t)(b * SEQ + tok) * 128 + kvh * 64 + ch * 8; kv = *(const u32x4*)(Kb + off); vv = *(const u32x4*)(Vb + off); }
        *(LAS u32x4*)(lds + ALDS_K + r * KS_PITCH + ch * 16) = kv;
#pragma unroll
        for (int j = 0; j < 4; ++j) { vt[(8 * ch + 2 * j) * (VT_PITCH / 2) + r] = (unsigned short)(vv[j] & 0xffffu); vt[(8 * ch + 2 * j + 1) * (VT_PITCH / 2) + r] = (unsigned short)(vv[j] >> 16); }
    }
    __syncthreads();
    const int h = kvh * 8 + wave, hi = lane >> 5, ql = lane & 31;
    const float sink2 = sinks[h] * 1.4426950408889634f;
    const size_t rowbase = (size_t)b * SEQ + nb * 128;
    const float NEG = -__builtin_inff();
    for (int g = 0; g < 4; ++g) {
        bf16x8 qr[4];
        const bf16* qp = Qb + (rowbase + 32 * g + ql) * 1024 + h * 64 + 8 * hi;
#pragma unroll
        for (int kk = 0; kk < 4; ++kk) qr[kk] = *(const bf16x8*)(qp + 16 * kk);
        f32x16 sc[5];
#pragma unroll
        for (int t5 = 0; t5 < 5; ++t5) {
            const LAS unsigned char* kp = lds + ALDS_K + (32 * (g + t5) + ql) * KS_PITCH + 16 * hi;
            f32x16 acc = {};
#pragma unroll
            for (int kk = 0; kk < 4; ++kk) acc = __builtin_amdgcn_mfma_f32_32x32x16_bf16(*(const LAS bf16x8*)(kp + 32 * kk), qr[kk], acc, 0, 0, 0);
            sc[t5] = acc;
        }
#pragma unroll
        for (int r = 0; r < 16; ++r) { const int cr = crow(r, hi); if (!(cr > ql)) sc[0][r] = NEG; if (!(cr <= ql)) sc[4][r] = NEG; }
        if (nb == 0) {
#pragma unroll
            for (int t5 = 0; t5 < 4; ++t5) if (g + t5 < 4) {
#pragma unroll
                for (int r = 0; r < 16; ++r) sc[t5][r] = NEG; }
        }
        float mx = sink2;
#pragma unroll
        for (int t5 = 0; t5 < 5; ++t5)
#pragma unroll
            for (int r = 0; r < 16; ++r) mx = fmaxf(mx, sc[t5][r]);
        mx = fmaxf(mx, __shfl_xor(mx, 32));
        float l = 0.f;
#pragma unroll
        for (int t5 = 0; t5 < 5; ++t5)
#pragma unroll
            for (int r = 0; r < 16; ++r) { const float p = __builtin_amdgcn_exp2f(sc[t5][r] - mx); sc[t5][r] = p; l += p; }
        l += __shfl_xor(l, 32);
        l += __builtin_amdgcn_exp2f(sink2 - mx);
        const float rl = 1.0f / l;
        f32x16 o[2]; o[0] = (f32x16){}; o[1] = (f32x16){};
#pragma unroll
        for (int t5 = 0; t5 < 5; ++t5)
#pragma unroll
            for (int h2 = 0; h2 < 2; ++h2) {
                u32x4 pw;
                pw.x = pg8::cvt_pk_bf16(sc[t5][8 * h2 + 0], sc[t5][8 * h2 + 1]); pw.y = pg8::cvt_pk_bf16(sc[t5][8 * h2 + 2], sc[t5][8 * h2 + 3]);
                pw.z = pg8::cvt_pk_bf16(sc[t5][8 * h2 + 4], sc[t5][8 * h2 + 5]); pw.w = pg8::cvt_pk_bf16(sc[t5][8 * h2 + 6], sc[t5][8 * h2 + 7]);
                const bf16x8 pb = __builtin_bit_cast(bf16x8, pw);
                const int s0 = 32 * (g + t5) + 16 * h2 + 4 * hi;
#pragma unroll
                for (int d0 = 0; d0 < 2; ++d0) {
                    const LAS unsigned char* vp = lds + ALDS_VT + (32 * d0 + ql) * VT_PITCH + s0 * 2;
                    const s16x4 lo = *(const LAS s16x4*)vp, hh = *(const LAS s16x4*)(vp + 16);
                    const bf16x8 va = (bf16x8){lo[0], lo[1], lo[2], lo[3], hh[0], hh[1], hh[2], hh[3]};
                    o[d0] = __builtin_amdgcn_mfma_f32_32x32x16_bf16(va, pb, o[d0], 0, 0, 0);
                }
            }
        bf16* op = MIX + (rowbase + 32 * g + ql) * 2048 + h * 64 + 4 * hi;
#pragma unroll
        for (int d0 = 0; d0 < 2; ++d0)
#pragma unroll
            for (int q4 = 0; q4 < 4; ++q4) { u32x2 w; w.x = pg8::cvt_pk_bf16(o[d0][4 * q4] * rl, o[d0][4 * q4 + 1] * rl); w.y = pg8::cvt_pk_bf16(o[d0][4 * q4 + 2] * rl, o[d0][4 * q4 + 3] * rl);
                *(u32x2*)(op + 32 * d0 + 8 * q4) = w; }
    }
    __syncthreads();
}

__device__ __forceinline__ void conv_phase(LAS unsigned char* lds, const bf16* __restrict__ U, const float* __restrict__ w_dw, const float* __restrict__ b_dw, const float* __restrict__ lng, const float* __restrict__ lnb,
                                           bf16* __restrict__ U2, int tid, int lane, int wave, int blk, int G) {
    f32x2 w[31];
#pragma unroll
    for (int j = 0; j < 31; ++j) w[j] = *(const f32x2*)(w_dw + j * 1024 + 2 * tid);
    const f32x2 bd = *(const f32x2*)(b_dw + 2 * tid);
    LAS float* T = (LAS float*)lds;
    for (int item = blk; item < M / 16; item += G) {
        const int row0 = item * 16, t0 = row0 & (SEQ - 1);
        f32x2 acc[16];
#pragma unroll
        for (int tt = 0; tt < 16; ++tt) acc[tt] = bd;
        const unsigned* up = (const unsigned*)U + ((ptrdiff_t)(row0 - 30) * 512 + tid);
#pragma unroll
        for (int i = 0; i < 46; ++i) {
            unsigned raw = 0u;
            if (t0 - 30 + i >= 0) raw = up[(ptrdiff_t)i * 512];
            const f32x2 xv = (f32x2){bf_lo(raw), bf_hi(raw)};
#pragma unroll
            for (int tt = (i > 30 ? i - 30 : 0); tt <= (i < 15 ? i : 15); ++tt) acc[tt] += w[i - tt] * xv;
        }
#pragma unroll
        for (int tt = 0; tt < 16; ++tt) *(LAS f32x2*)(T + tt * 1024 + 2 * tid) = acc[tt];
        __syncthreads();
#pragma unroll
        for (int tq = 0; tq < 2; ++tq) {
            const int tt = 2 * wave + tq;
            f32x4 v[4]; float s = 0.f;
#pragma unroll
            for (int k = 0; k < 4; ++k) { v[k] = *(const LAS f32x4*)(T + tt * 1024 + 256 * k + 4 * lane); s += (v[k][0] + v[k][1]) + (v[k][2] + v[k][3]); }
            const float mean = wave_sum(s) * (1.0f / 1024.0f); float s2 = 0.f;
#pragma unroll
            for (int k = 0; k < 4; ++k) { v[k] = v[k] - mean; s2 += (v[k][0] * v[k][0] + v[k][1] * v[k][1]) + (v[k][2] * v[k][2] + v[k][3] * v[k][3]); }
            const float rstd = 1.0f / sqrtf(wave_sum(s2) * (1.0f / 1024.0f) + LN_EPS);
#pragma unroll
            for (int k = 0; k < 4; ++k) { const f32x4 gg = *(const f32x4*)(lng + 256 * k + 4 * lane), bb = *(const f32x4*)(lnb + 256 * k + 4 * lane);
                f32x4 y = v[k] * rstd * gg + bb;
                y = (f32x4){y[0] * pg8::sigmoidf_fast(y[0]), y[1] * pg8::sigmoidf_fast(y[1]), y[2] * pg8::sigmoidf_fast(y[2]), y[3] * pg8::sigmoidf_fast(y[3])};
                u32x2 o; o.x = pg8::cvt_pk_bf16(y[0], y[1]); o.y = pg8::cvt_pk_bf16(y[2], y[3]);
                *(u32x2*)(U2 + (size_t)(row0 + tt) * 1024 + 256 * k + 4 * lane) = o; }
        }
        __syncthreads();
    }
}

template <bool WB>
__device__ __forceinline__ void ln_phase(const float* __restrict__ Y, const float* __restrict__ g, const float* __restrict__ b, float* __restrict__ outf, bf16* __restrict__ outb, int gw, int NGW, int lane) {
    f32x4 gv[8], bv[8];
#pragma unroll
    for (int j = 0; j < 8; ++j) { gv[j] = ((const f32x4*)g)[64 * j + lane]; bv[j] = ((const f32x4*)b)[64 * j + lane]; }
    for (int m = gw; m < M; m += NGW) {
        const f32x4* yr = (const f32x4*)(Y + (size_t)m * DM) + lane;
        f32x4 v[8]; float s = 0.f;
#pragma unroll
        for (int j = 0; j < 8; ++j) { v[j] = yr[64 * j]; s += (v[j][0] + v[j][1]) + (v[j][2] + v[j][3]); }
        const float mean = wave_sum(s) * (1.0f / DM); float s2 = 0.f;
#pragma unroll
        for (int j = 0; j < 8; ++j) { v[j] = v[j] - mean; s2 += (v[j][0] * v[j][0] + v[j][1] * v[j][1]) + (v[j][2] * v[j][2] + v[j][3] * v[j][3]); }
        const float rstd = 1.0f / sqrtf(wave_sum(s2) * (1.0f / DM) + LN_EPS);
        f32x4* of = (f32x4*)(outf + (size_t)m * DM) + lane; u32x2* ob = (u32x2*)(outb + (size_t)m * DM) + lane;
#pragma unroll
        for (int j = 0; j < 8; ++j) { const f32x4 y = v[j] * rstd * gv[j] + bv[j]; of[64 * j] = y;
            if (WB) { u32x2 o; o.x = pg8::cvt_pk_bf16(y[0], y[1]); o.y = pg8::cvt_pk_bf16(y[2], y[3]); ob[64 * j] = o; } }
    }
}

__global__ void __launch_bounds__(NTHR, 2) fwd_megakernel(Args a) {
    extern __shared__ __attribute__((aligned(16))) unsigned char lds_raw[];
    LAS unsigned char* lds = (LAS unsigned char*)lds_raw;
    cg::grid_group grid = cg::this_grid();
    const int tid = threadIdx.x, lane = tid & 63, wave = __builtin_amdgcn_readfirstlane(tid >> 6), blk = blockIdx.x, G = gridDim.x;
    unsigned char* ws = a.ws;
    const int lo = a.ph_lo, hi = a.ph_hi;
#define IN(k) (lo <= (k) && (k) < hi)
#define SEAM(k) do { if (IN(k) && IN((k) + 1)) grid.sync(); } while (0)
    bf16* XB = (bf16*)(ws + WS_XB); bf16* QB = (bf16*)(ws + WS_Q); bf16* KB = (bf16*)(ws + WS_K); bf16* VB = (bf16*)(ws + WS_V); bf16* UB = (bf16*)(ws + WS_U); bf16* U2 = (bf16*)(ws + WS_U2);
    bf16* MIX = (bf16*)(ws + WS_MIX); bf16* HB = (bf16*)(ws + WS_H); float* Y = (float*)(ws + WS_Y); bf16* X1B = (bf16*)(ws + WS_X1B);
    const float* cs = (const float*)(ws + WS_ROPE); const float* sn = cs + (size_t)M * 32;

    if (IN(0)) { prologue(a, lds, tid, lane, wave, blk, G); }
    SEAM(0);
    if (IN(1)) {
        pg8::Gemm g{XB, (const bf16*)(ws + WS_WIN), M, NIN, DM}; pg8::StaticOrder S; S.init(M, NIN, G, blk);
        pg8::EpiIn E{QB, KB, VB, UB, (const float*)a.in[3], cs, sn};
        pg8::gemm_phase<pg8::EpiIn, pg8::StaticOrder, true, true>(lds, g, S, E);
    }
    SEAM(1);
    if (IN(2)) {
        for (int item = blk; item < BATCH * 16 * 2; item += G) attn_item(lds, item >> 5, (item >> 1) & 15, item & 1, QB, KB, VB, MIX, (const float*)a.in[4], tid, lane, wave);
        conv_phase(lds, UB, (const float*)a.in[5], (const float*)a.in[6], (const float*)a.in[7], (const float*)a.in[8], U2, tid, lane, wave, blk, G);
    }
    SEAM(2);
    if (IN(3)) {
        pg8::Gemm g{U2, (const bf16*)(ws + WS_WPW), M, CWID, CWID}; pg8::StaticOrder S; S.init(M, CWID, G, blk);
        pg8::EpiBias16 E{MIX, DM, 1024, (const float*)a.in[10]};
        pg8::gemm_phase<pg8::EpiBias16, pg8::StaticOrder, true, true>(lds, g, S, E);
    }
    SEAM(3);
    if (IN(4)) {
        pg8::Gemm g{MIX, (const bf16*)(ws + WS_WOUT), M, DM, DM}; pg8::StaticOrder S; S.init(M, DM, G, blk);
        pg8::EpiRes E{(const float*)a.in[0], Y, DM, (const float*)a.in[12], ALPHA};
        pg8::gemm_phase<pg8::EpiRes, pg8::StaticOrder, true, true>(lds, g, S, E);
    }
    SEAM(4);
    if (IN(5)) { ln_phase<true>(Y, (const float*)a.in[13], (const float*)a.in[14], a.out, X1B, blk * NWAVES + wave, G * NWAVES, lane); }
    SEAM(5);
    if (IN(6)) {
        pg8::Gemm g{X1B, (const bf16*)(ws + WS_WGU), M, 2 * DFF, DM}; pg8::StaticOrder S; S.init(M, 2 * DFF, G, blk);
        pg8::EpiSwiGLU E{HB, DFF};
        pg8::gemm_phase<pg8::EpiSwiGLU, pg8::StaticOrder, true, true>(lds, g, S, E);
    }
    SEAM(6);
    if (IN(7)) {
        pg8::Gemm g{HB, (const bf16*)(ws + WS_WDN), M, DM, DFF}; pg8::StaticOrder S; S.init(M, DM, G, blk);
        pg8::EpiRes E{a.out, Y, DM, nullptr, ALPHA};
        pg8::gemm_phase<pg8::EpiRes, pg8::StaticOrder, true, true>(lds, g, S, E);
    }
    SEAM(7);
    if (IN(8)) { ln_phase<false>(Y, (const float*)a.in[18], (const float*)a.in[19], a.out, nullptr, blk * NWAVES + wave, G * NWAVES, lane); }
#undef IN
#undef SEAM
}

extern "C" void kernel_launch(void* const* d_in, const int* in_sizes, int n_in, void* d_out, int out_size, void* d_ws, size_t ws_size, hipStream_t stream) {
    static int grid = 0;
    if (grid == 0) {
        if (n_in != 20 || in_sizes[0] != M * DM || out_size != M * DM || ws_size < WS_END) { fprintf(stderr, "kernel_launch: unexpected shapes (n_in %d, in0 %d, out %d, ws %zu)\n", n_in, n_in > 0 ? in_sizes[0] : -1, out_size, ws_size); grid = -1; return; }
        int dev = 0, cus = 0, per_cu = 0;
        if (hipGetDevice(&dev) != hipSuccess || hipDeviceGetAttribute(&cus, hipDeviceAttributeMultiprocessorCount, dev) != hipSuccess) { fprintf(stderr, "kernel_launch: device query failed\n"); grid = -1; return; }
        if (hipFuncSetAttribute((const void*)fwd_megakernel, hipFuncAttributeMaxDynamicSharedMemorySize, LDS_BYTES) != hipSuccess) { fprintf(stderr, "kernel_launch: hipFuncSetAttribute failed\n"); grid = -1; return; }
        if (hipOccupancyMaxActiveBlocksPerMultiprocessor(&per_cu, (const void*)fwd_megakernel, NTHR, LDS_BYTES) != hipSuccess || per_cu < 1) { fprintf(stderr, "kernel_launch: occupancy query says %d blocks/CU; using 1\n", per_cu); per_cu = 1; }
        (void)hipGetLastError();
        grid = cus * per_cu;
        fprintf(stderr, "kernel_launch: %d CUs x %d blocks/CU -> grid %d\n", cus, per_cu, grid);
    }
    if (grid < 0) return;
    Args a{};
    for (int i = 0; i < 20; ++i) a.in[i] = d_in[i];
    a.out = (float*)d_out; a.ws = (unsigned char*)d_ws;
    constexpr int NL = MK_N_LAUNCHES;
    for (int li = 0; li < NL; ++li) {
        a.ph_lo = (NL == 1) ? 0 : li; a.ph_hi = (NL == 1) ? N_PHASES : li + 1;
        void* args[] = {&a};
        const hipError_t e = hipLaunchCooperativeKernel((const void*)fwd_megakernel, dim3(grid), dim3(NTHR), args, LDS_BYTES, stream);
        if (e != hipSuccess) { fprintf(stderr, "kernel_launch: cooperative launch %d failed: %s (grid %d)\n", li, hipGetErrorString(e), grid); break; }
    }
}
```
